# Optimizing an MI355X kernel written in HIP

```python
import functools
import jax, jax.numpy as jnp
from jax import lax
import numpy as np

D_MODEL = 1024
BATCH = 8
SEQ = 2048
DEPTH = 1
DEC_BATCH = 128
DEC_SEQ = 4
PAST_LEN = 16384
PAGE_SIZE = 128

N_HEADS = 16
N_KV_HEADS = 2
HEAD_DIM = 64
GROUP = N_HEADS // N_KV_HEADS
WINDOW = 128
ROPE_THETA = 10000.0
CHUNK = 128
A_GROUPS = 4
A_GROUP_DIM = 128
A_WIDTH = A_GROUPS * A_GROUP_DIM
D_FF = 2816
LN_EPS = 1e-5
NEG_INF = -1e30
DN_ALPHA = (2.0 * DEPTH) ** 0.25
DN_BETA = (8.0 * DEPTH) ** -0.25
Q_WIDTH = N_HEADS * HEAD_DIM
KV_WIDTH = N_KV_HEADS * HEAD_DIM
SPLIT_POINTS = [A_WIDTH, 2 * A_WIDTH, 2 * A_WIDTH + Q_WIDTH, 2 * A_WIDTH + Q_WIDTH + KV_WIDTH,
                2 * A_WIDTH + Q_WIDTH + 2 * KV_WIDTH, 2 * A_WIDTH + Q_WIDTH + 2 * KV_WIDTH + D_MODEL]
IN_WIDTH = 2 * A_WIDTH + Q_WIDTH + 2 * KV_WIDTH + 2 * D_MODEL

kernel_name = 'gated_gmlp_swa_sink_macaron_deepnorm_step'


def _layernorm(x, g, b):
    xf = x.astype(jnp.float32)
    mu = xf.mean(-1, keepdims=True)
    var = jnp.square(xf - mu).mean(-1, keepdims=True)
    y = (xf - mu) * lax.rsqrt(var + LN_EPS) * g.astype(jnp.float32) + b.astype(jnp.float32)
    return y.astype(x.dtype)


def _swiglu(x, w_up, w_down):
    g, u = jnp.split(x @ w_up, 2, axis=-1)
    return (jax.nn.silu(g) * u) @ w_down


def _rope(x, pos):
    half = HEAD_DIM // 2
    inv = ROPE_THETA ** (-jnp.arange(half, dtype=jnp.float32) / half)
    ang = pos.astype(jnp.float32)[:, None] * inv[None, :]
    cos = jnp.cos(ang)[:, None, :]
    sin = jnp.sin(ang)[:, None, :]
    xf = x.astype(jnp.float32)
    x1, x2 = xf[..., :half], xf[..., half:]
    return jnp.concatenate([x1 * cos - x2 * sin, x2 * cos + x1 * sin], axis=-1).astype(x.dtype)


def _sink_attend(q, k, v, mask, sinks):
    s = jnp.einsum('...qkgd,...skd->...kgqs', q, k).astype(jnp.float32) * (HEAD_DIM ** -0.5)
    s = jnp.where(mask, s, NEG_INF)
    sk = sinks.astype(jnp.float32).reshape(N_KV_HEADS, GROUP, 1, 1)
    m = jnp.maximum(s.max(-1, keepdims=True), sk)
    p = jnp.exp(s - m)
    w = p / (p.sum(-1, keepdims=True) + jnp.exp(sk - m))
    return jnp.einsum('...kgqs,...skd->...qkgd', w.astype(v.dtype), v)


def _attend_prompt(q, k, v, sinks, buf):
    B, L = q.shape[0], q.shape[1]
    nb = L // WINDOW
    qb = q.reshape(B, nb, WINDOW, N_KV_HEADS, GROUP, HEAD_DIM)

    def two_blocks(t):
        tb = t.reshape(B, nb, WINDOW, N_KV_HEADS, HEAD_DIM)
        prev = jnp.pad(tb, ((0, 0), (1, 0), (0, 0), (0, 0), (0, 0)))[:, :nb]
        return jnp.concatenate([prev, tb], axis=2)

    i = jnp.arange(WINDOW)[:, None]
    j = jnp.arange(2 * WINDOW)[None, :]
    d = i + WINDOW - j
    band = (d >= 0) & (d < WINDOW)
    valid = (jnp.arange(nb) > 0)[:, None, None] | (j >= WINDOW)[None]
    mask = (band[None] & valid)[None, :, None, None]
    out = _sink_attend(qb, two_blocks(k), two_blocks(v), mask, sinks)
    return out.reshape(B, L, Q_WIDTH), k[:, L - buf:], v[:, L - buf:]


def _attend_sample(q, k, v, sinks, k_buf, v_buf):
    B, T = q.shape[0], q.shape[1]
    buf = k_buf.shape[1]
    kk = jnp.concatenate([k_buf.astype(k.dtype), k], axis=1)
    vv = jnp.concatenate([v_buf.astype(v.dtype), v], axis=1)
    qpos = PAST_LEN + jnp.arange(T)
    kpos = PAST_LEN - buf + jnp.arange(buf + T)
    d = qpos[:, None] - kpos[None, :]
    mask = (d >= 0) & (d < WINDOW)
    out = _sink_attend(q, kk, vv, mask, sinks)
    return out.reshape(B, T, Q_WIDTH), kk[:, T:], vv[:, T:]


def _chunk_gmlp(u, v, ln_g, ln_b, ws, bs):
    B, L = u.shape[0], u.shape[1]
    vn = _layernorm(v, ln_g, ln_b)
    nc = -(-L // CHUNK)
    lp = nc * CHUNK
    vc = jnp.pad(vn, ((0, 0), (0, lp - L), (0, 0))).reshape(B, nc, CHUNK, A_GROUPS, A_GROUP_DIM)
    causal = jnp.tril(jnp.ones((CHUNK, CHUNK), dtype=bool))
    wm = jnp.where(causal[None], ws, jnp.zeros_like(ws)).astype(vc.dtype)
    mixed = jnp.einsum('gts,bnsgc->bntgc', wm, vc) + bs.T[:, :, None].astype(vc.dtype)
    mixed = mixed.reshape(B, lp, A_WIDTH)[:, :L]
    start = ((L - 1) // CHUNK) * CHUNK
    return u * mixed, vn[:, start:]


def _layer(x, pos, attend, p):
    (ffn1_up, ffn1_down, ln1_g, ln1_b, w_in, a_ln_g, a_ln_b, a_ws, a_bs, attn_sinks,
     w_pa, w_pb, w_o, ln2_g, ln2_b, ffn2_up, ffn2_down, ln3_g, ln3_b) = p
    B, L = x.shape[0], x.shape[1]
    h = _layernorm(DN_ALPHA * x + 0.5 * _swiglu(x, ffn1_up, ffn1_down), ln1_g, ln1_b)
    a_u, a_v, q, k, v, g_a, g_b = jnp.split(h @ w_in, SPLIT_POINTS, axis=-1)
    a_out, a_state = _chunk_gmlp(jax.nn.gelu(a_u), jax.nn.gelu(a_v), a_ln_g, a_ln_b, a_ws, a_bs)
    q = _rope(q.reshape(B, L, N_HEADS, HEAD_DIM), pos).reshape(B, L, N_KV_HEADS, GROUP, HEAD_DIM)
    k = _rope(k.reshape(B, L, N_KV_HEADS, HEAD_DIM), pos)
    v = v.reshape(B, L, N_KV_HEADS, HEAD_DIM)
    b_out, k_state, v_state = attend(q, k, v, attn_sinks)
    merged = jax.nn.sigmoid(g_a) * (a_out @ w_pa) + jax.nn.sigmoid(g_b) * (b_out @ w_pb)
    h = _layernorm(DN_ALPHA * h + merged @ w_o, ln2_g, ln2_b)
    h = _layernorm(DN_ALPHA * h + 0.5 * _swiglu(h, ffn2_up, ffn2_down), ln3_g, ln3_b)
    return h, k_state, v_state, a_state


def setup_inputs(seed: int = 0) -> dict:
    key = jax.random.key(seed)
    ks = jax.random.split(key, 32)
    f32 = jnp.float32
    buf = min(WINDOW, PAST_LEN)

    def nrm(k, shape, scale):
        return jax.random.normal(k, shape, f32) * scale

    def gain(k, n):
        return 1.0 + nrm(k, (DEPTH, n), 0.02)

    return {
        'x_prompt': nrm(ks[0], (BATCH, SEQ, D_MODEL), 1.0),
        'x_sample': nrm(ks[1], (DEC_BATCH, DEC_SEQ, D_MODEL), 1.0),
        'cache_win_k': nrm(ks[2], (DEPTH, DEC_BATCH, buf, N_KV_HEADS, HEAD_DIM), 1.0),
        'cache_win_v': nrm(ks[3], (DEPTH, DEC_BATCH, buf, N_KV_HEADS, HEAD_DIM), 1.0),
        'ffn1_up': nrm(ks[4], (DEPTH, D_MODEL, 2 * D_FF), D_MODEL ** -0.5),
        'ffn1_down': nrm(ks[5], (DEPTH, D_FF, D_MODEL), DN_BETA * D_FF ** -0.5),
        'ln1_g': gain(ks[6], D_MODEL),
        'ln1_b': nrm(ks[7], (DEPTH, D_MODEL), 0.02),
        'w_in': nrm(ks[8], (DEPTH, D_MODEL, IN_WIDTH), D_MODEL ** -0.5),
        'a_ln_g': gain(ks[9], A_WIDTH),
        'a_ln_b': nrm(ks[10], (DEPTH, A_WIDTH), 0.02),
        'a_ws': nrm(ks[11], (DEPTH, A_GROUPS, CHUNK, CHUNK), CHUNK ** -0.5),
        'a_bs': 1.0 + nrm(ks[12], (DEPTH, A_GROUPS, CHUNK), 0.02),
        'attn_sinks': nrm(ks[13], (DEPTH, N_HEADS), 0.5),
        'w_pa': nrm(ks[14], (DEPTH, A_WIDTH, D_MODEL), A_WIDTH ** -0.5),
        'w_pb': nrm(ks[15], (DEPTH, Q_WIDTH, D_MODEL), Q_WIDTH ** -0.5),
        'w_o': nrm(ks[16], (DEPTH, D_MODEL, D_MODEL), DN_BETA * D_MODEL ** -0.5),
        'ln2_g': gain(ks[17], D_MODEL),
        'ln2_b': nrm(ks[18], (DEPTH, D_MODEL), 0.02),
        'ffn2_up': nrm(ks[19], (DEPTH, D_MODEL, 2 * D_FF), D_MODEL ** -0.5),
        'ffn2_down': nrm(ks[20], (DEPTH, D_FF, D_MODEL), DN_BETA * D_FF ** -0.5),
        'ln3_g': gain(ks[21], D_MODEL),
        'ln3_b': nrm(ks[22], (DEPTH, D_MODEL), 0.02),
    }


def reference(x_prompt, x_sample, cache_win_k, cache_win_v, ffn1_up, ffn1_down, ln1_g, ln1_b,
              w_in, a_ln_g, a_ln_b, a_ws, a_bs, attn_sinks, w_pa, w_pb, w_o, ln2_g, ln2_b,
              ffn2_up, ffn2_down, ln3_g, ln3_b):
    buf = cache_win_k.shape[2]
    weights = (ffn1_up, ffn1_down, ln1_g, ln1_b, w_in, a_ln_g, a_ln_b, a_ws, a_bs, attn_sinks,
               w_pa, w_pb, w_o, ln2_g, ln2_b, ffn2_up, ffn2_down, ln3_g, ln3_b)
    pos_p = jnp.arange(x_prompt.shape[1])
    pos_s = PAST_LEN + jnp.arange(x_sample.shape[1])
    hp, hs = x_prompt, x_sample
    kp_l, vp_l, ks_l, vs_l, ap_l, as_l = [], [], [], [], [], []
    for l in range(DEPTH):
        p = tuple(w[l] for w in weights)
        hp, kp, vp, ap = _layer(hp, pos_p, functools.partial(_attend_prompt, buf=buf), p)
        hs, ks_, vs_, as_ = _layer(hs, pos_s, functools.partial(_attend_sample, k_buf=cache_win_k[l], v_buf=cache_win_v[l]), p)
        kp_l.append(kp); vp_l.append(vp); ap_l.append(ap)
        ks_l.append(ks_); vs_l.append(vs_); as_l.append(as_)
    win_k_prompt = jnp.stack(kp_l)
    win_v_prompt = jnp.stack(vp_l)
    win_k_sample = jnp.stack(ks_l)
    win_v_sample = jnp.stack(vs_l)
    chunk_v_prompt = jnp.stack(ap_l)
    chunk_v_sample = jnp.stack(as_l)
    return (hp, hs, win_k_prompt, win_v_prompt, win_k_sample, win_v_sample, chunk_v_prompt, chunk_v_sample)
```

```cpp
#include <hip/hip_runtime.h>
#include <cstdio>
#include <cstdint>

#ifndef PHASE_MASK
#define PHASE_MASK 0xFFF
#endif
#ifndef MK_N_LAUNCHES
#define MK_N_LAUNCHES 1
#endif

namespace pg8 {
#define PG8_LAS __attribute__((address_space(3)))
typedef unsigned short bf16_t;
typedef short bf16x8 __attribute__((ext_vector_type(8)));
typedef float f32x4 __attribute__((ext_vector_type(4)));
typedef unsigned u32x4 __attribute__((ext_vector_type(4)));
constexpr int BM = 256, BK = 64, HALF = 128, HTB = HALF * BK * 2  , STAGE_BYTES = 8 * HTB, NXCD = 8, WGM = 8;

__host__ __device__ __forceinline__ int lds_byte(int r, int c) { const int st = (r >> 4) * 2 + (c >> 5), rr = r & 15, cc = c & 31, ob = rr * 64 + cc * 2; return st * 1024 + (ob ^ (((ob >> 9) & 1) << 5)); }
__host__ __device__ __forceinline__ void stage_rc(int b, int& R, int& C) { const int st = b / 1024, sb = b % 1024, swz = sb ^ (((sb >> 9) & 1) << 5); R = (st >> 1) * 16 + swz / 64; C = (st & 1) * 32 + (swz % 64) / 2; }
__host__ __device__ __forceinline__ int perm32(int rho) { const int n = rho >> 4, i = rho & 15; return 8 * (i >> 2) + 4 * n + (i & 3); }

struct Unit { int pm, pn, k0, nt, seg; };
struct Gemm { const bf16_t* A; const bf16_t* Bt; int M, N, K; };

struct StaticOrder {
    static constexpr bool SEG = false;
    int nM, nN, nwg, G, c;
    __host__ __device__ void init(int M, int N, int G_, int c_) { nM = M / BM; nN = N / BM; nwg = nM * nN; G = G_; c = c_; }
    __host__ __device__ bool next(int i, Unit& u) const {
        const long L = (long)i * G + c; if (L >= nwg) return false;
        int wgid = (int)L; { const int q = nwg / NXCD, r = nwg % NXCD, xcd = wgid % NXCD, off = wgid / NXCD; wgid = (xcd < r ? xcd * (q + 1) : r * (q + 1) + (xcd - r) * q) + off; }
        const int nig = WGM * nN, gid = wgid / nig, fm = gid * WGM, gsz = (nM - fm) < WGM ? (nM - fm) : WGM;
        u.pm = fm + ((wgid % nig) % gsz); u.pn = (wgid % nig) / gsz; return true;
    }
    __device__ __forceinline__ void a_ready(const Unit&) const {}
    __device__ __forceinline__ void done(const Unit&) const {}
};
struct TwoSegOrder : StaticOrder {
    static constexpr bool SEG = true;
    int nt0, nt1;
    __host__ __device__ bool next(int i, Unit& u) const { if (!StaticOrder::next(i >> 1, u)) return false; u.seg = i & 1; u.k0 = (i & 1) ? nt0 * BK : 0; u.nt = (i & 1) ? nt1 : nt0; return true; }
};

__device__ __forceinline__ unsigned cvt_pk_bf16(float lo, float hi) { unsigned r; asm volatile("v_cvt_pk_bf16_f32 %0, %1, %2" : "=v"(r) : "v"(lo), "v"(hi)); return r; }
__device__ __forceinline__ float bf_lo(unsigned w) { return __uint_as_float(w << 16); }
__device__ __forceinline__ float bf_hi(unsigned w) { return __uint_as_float(w & 0xffff0000u); }
__device__ __forceinline__ float sigmoidf_(float x) { return __builtin_amdgcn_rcpf(1.0f + __builtin_amdgcn_exp2f(-1.4426950408889634f * x)); }
__device__ __forceinline__ float gelu_tanh(float x) { const float u = x * (1.5957691216057308f + 0.07135481627f * x * x); return x * sigmoidf_(u); }


struct EpiSwiGLU {
    static constexpr bool PERM = true, AFTER_DRAIN = false; static constexpr int MID_T = -1;
    bf16_t* O;
    __device__ __forceinline__ void mid(f32x4 (&)[2][2][4][2], const Unit&, int, int, int, int) const {}
    __device__ __forceinline__ void operator()(const f32x4 (&acc)[2][2][4][2], const Unit& u, int wr, int wc, int fr, int fq) const {
        const int row0 = u.pm * BM + wr * 64 + fr, col0 = u.pn * 128 + wc * 32 + 8 * fq;
#pragma unroll
        for (int ai = 0; ai < 2; ++ai)
#pragma unroll
            for (int m = 0; m < 4; ++m) { bf16_t* rowp = O + (size_t)(row0 + ai * HALF + m * 16) * 2816 + col0;
                float v[8];
#pragma unroll
                for (int n = 0; n < 2; ++n)
#pragma unroll
                    for (int j = 0; j < 4; ++j) { const float g = acc[ai][0][m][n][j], uu = acc[ai][1][m][n][j]; v[n * 4 + j] = g * sigmoidf_(g) * uu; }
                u32x4 w; w.x = cvt_pk_bf16(v[0], v[1]); w.y = cvt_pk_bf16(v[2], v[3]); w.z = cvt_pk_bf16(v[4], v[5]); w.w = cvt_pk_bf16(v[6], v[7]);
                *(u32x4*)rowp = w; }
    }
};

template <bool RES_BF16> struct EpiResZ {
    static constexpr bool PERM = true, AFTER_DRAIN = false; static constexpr int MID_T = -1;
    const void* res0; const void* res1; int split_row; float* Z; float alpha, s;
    __device__ __forceinline__ void mid(f32x4 (&)[2][2][4][2], const Unit&, int, int, int, int) const {}
    __device__ __forceinline__ void operator()(const f32x4 (&acc)[2][2][4][2], const Unit& u, int wr, int wc, int fr, int fq) const {
        const int row0 = u.pm * BM + wr * 64 + fr, col0 = u.pn * BM + wc * 32 + 8 * fq;
        const bool second = (u.pm * BM >= split_row);
        const char* rbase = (const char*)(second ? res1 : res0); const int rsub = second ? split_row : 0;
#pragma unroll
        for (int ai = 0; ai < 2; ++ai)
#pragma unroll
            for (int m = 0; m < 4; ++m) { const int row = row0 + ai * HALF + m * 16;
#pragma unroll
                for (int bj = 0; bj < 2; ++bj) { const int col = col0 + bj * HALF;
                    f32x4 r0, r1;
                    if (RES_BF16) { const u32x4 w = *(const u32x4*)(rbase + ((size_t)(row - rsub) * 1024 + col) * 2);
                        r0 = (f32x4){bf_lo(w.x), bf_hi(w.x), bf_lo(w.y), bf_hi(w.y)}; r1 = (f32x4){bf_lo(w.z), bf_hi(w.z), bf_lo(w.w), bf_hi(w.w)}; }
                    else { const float* rp = (const float*)rbase + (size_t)(row - rsub) * 1024 + col; r0 = *(const f32x4*)rp; r1 = *(const f32x4*)(rp + 4); }
                    float* zp = Z + (size_t)row * 1024 + col;
                    *(f32x4*)zp = r0 * alpha + acc[ai][bj][m][0] * s; *(f32x4*)(zp + 4) = r1 * alpha + acc[ai][bj][m][1] * s; } }
    }
};

struct EpiWin {
    static constexpr bool PERM = true, AFTER_DRAIN = false; static constexpr int MID_T = -1;
    bf16_t *QA, *GV, *KB, *VB, *SA, *SB; const float* rope; float *wkp, *wvp, *wks, *wvs; float qscale;
    __device__ __forceinline__ void mid(f32x4 (&)[2][2][4][2], const Unit&, int, int, int, int) const {}
    __device__ __forceinline__ static u32x4 pack8(const f32x4& a, const f32x4& b) { u32x4 w; w.x = cvt_pk_bf16(a[0], a[1]); w.y = cvt_pk_bf16(a[2], a[3]); w.z = cvt_pk_bf16(b[0], b[1]); w.w = cvt_pk_bf16(b[2], b[3]); return w; }
    __device__ __forceinline__ void operator()(const f32x4 (&acc)[2][2][4][2], const Unit& u, int wr, int wc, int fr, int fq) const {
        const int row0 = u.pm * BM + wr * 64 + fr, pn = u.pn, cw = wc * 32 + 8 * fq;
        if (pn < 4 || pn >= 9) {
            bf16_t* base; int pitch, colt; int act;
            if (pn < 2) { base = QA; pitch = 1536; colt = pn * 256; act = 0; }
            else if (pn < 4) { base = GV; pitch = 512; colt = (pn - 2) * 256; act = 0; }
            else if (pn < 13) { base = SA; pitch = 1024; colt = (pn - 9) * 256; act = 1; }
            else { base = SB; pitch = 1024; colt = (pn - 13) * 256; act = 1; }
#pragma unroll
            for (int ai = 0; ai < 2; ++ai)
#pragma unroll
                for (int m = 0; m < 4; ++m) { bf16_t* rowp = base + (size_t)(row0 + ai * HALF + m * 16) * pitch + colt + cw;
#pragma unroll
                    for (int bj = 0; bj < 2; ++bj) { f32x4 v0 = acc[ai][bj][m][0], v1 = acc[ai][bj][m][1];
#pragma unroll
                        for (int j = 0; j < 4; ++j) { v0[j] = act ? sigmoidf_(v0[j]) : gelu_tanh(v0[j]); v1[j] = act ? sigmoidf_(v1[j]) : gelu_tanh(v1[j]); }
                        *(u32x4*)(rowp + bj * HALF) = pack8(v0, v1); } }
        } else {
            const bool isq = pn < 8; const bool isv = (!isq) && wc >= 2;
#pragma unroll
            for (int ai = 0; ai < 2; ++ai)
#pragma unroll
                for (int m = 0; m < 4; ++m) { const int row = row0 + ai * HALF + m * 16;
                    const int ridx = row < 16384 ? (row & 2047) : 2048 + (row & 3);
                    f32x4 o1a, o1b, o2a, o2b;
                    if (!isv) { const float* tp = rope + (size_t)ridx * 64 + 8 * fq;
                        const f32x4 c0 = *(const f32x4*)tp, c1 = *(const f32x4*)(tp + 4), s0 = *(const f32x4*)(tp + 32), s1 = *(const f32x4*)(tp + 36);
                        const f32x4 x1a = acc[ai][0][m][0], x1b = acc[ai][0][m][1], x2a = acc[ai][1][m][0], x2b = acc[ai][1][m][1];
                        o1a = x1a * c0 - x2a * s0; o1b = x1b * c1 - x2b * s1; o2a = x2a * c0 + x1a * s0; o2b = x2b * c1 + x1b * s1;
                    } else { o1a = acc[ai][0][m][0]; o1b = acc[ai][0][m][1]; o2a = acc[ai][1][m][0]; o2b = acc[ai][1][m][1]; }
                    if (isq) { const int head = (pn - 4) * 4 + wc; bf16_t* qp = QA + (size_t)row * 1536 + 512 + head * 64 + 8 * fq;
                        *(u32x4*)qp = pack8(o1a * qscale, o1b * qscale); *(u32x4*)(qp + 32) = pack8(o2a * qscale, o2b * qscale);
                    } else {
                        const int c1 = isv ? (wc - 2) * 32 + 8 * fq : wc * 64 + 8 * fq, c2 = isv ? c1 + 64 : c1 + 32;
                        bf16_t* dp = (isv ? VB : KB) + (size_t)row * 128;
                        *(u32x4*)(dp + c1) = pack8(o1a, o1b); *(u32x4*)(dp + c2) = pack8(o2a, o2b);
                        float* op = nullptr;
                        if (row >= 16384) { const int sb = (row - 16384) >> 2, t = row & 3; op = (isv ? wvs : wks) + ((size_t)sb * 128 + 124 + t) * 128; }
                        else if ((row & 2047) >= 1920) { const int b = row >> 11, t = (row & 2047) - 1920; op = (isv ? wvp : wkp) + ((size_t)b * 128 + t) * 128; }
                        if (op) { *(f32x4*)(op + c1) = o1a; *(f32x4*)(op + c1 + 4) = o1b; *(f32x4*)(op + c2) = o2a; *(f32x4*)(op + c2 + 4) = o2b; }
                    } }
        }
    }
};

struct EpiMerged {
    static constexpr bool PERM = true, AFTER_DRAIN = false; static constexpr int MID_T = -1;
    const bf16_t *SA, *SB; bf16_t* O;
    __device__ __forceinline__ void mid(f32x4 (&acc)[2][2][4][2], const Unit& u, int wr, int wc, int fr, int fq) const {
        const int row0 = u.pm * BM + wr * 64 + fr, col0 = u.pn * BM + wc * 32 + 8 * fq;
#pragma unroll
        for (int ai = 0; ai < 2; ++ai)
#pragma unroll
            for (int m = 0; m < 4; ++m) { const size_t off = (size_t)(row0 + ai * HALF + m * 16) * 1024 + col0;
#pragma unroll
                for (int bj = 0; bj < 2; ++bj) { const u32x4 a = *(const u32x4*)(SA + off + bj * HALF), b = *(const u32x4*)(SB + off + bj * HALF);
                    const unsigned aw[4] = {a.x, a.y, a.z, a.w}, bw[4] = {b.x, b.y, b.z, b.w};
#pragma unroll
                    for (int q = 0; q < 4; ++q) { const float r0 = bf_lo(aw[q]) * __builtin_amdgcn_rcpf(fmaxf(bf_lo(bw[q]), 1e-20f)), r1 = bf_hi(aw[q]) * __builtin_amdgcn_rcpf(fmaxf(bf_hi(bw[q]), 1e-20f));
                        acc[ai][bj][m][q >> 1][(q & 1) * 2] *= r0; acc[ai][bj][m][q >> 1][(q & 1) * 2 + 1] *= r1; } }
                asm volatile("" : "+v"(acc[ai][0][m][0]), "+v"(acc[ai][0][m][1]), "+v"(acc[ai][1][m][0]), "+v"(acc[ai][1][m][1]) :: "memory"); }
    }
    __device__ __forceinline__ void operator()(f32x4 (&acc)[2][2][4][2], const Unit& u, int wr, int wc, int fr, int fq) const {
        if (u.seg == 0) { mid(acc, u, wr, wc, fr, fq); return; }
        const int row0 = u.pm * BM + wr * 64 + fr, col0 = u.pn * BM + wc * 32 + 8 * fq;
#pragma unroll
        for (int ai = 0; ai < 2; ++ai)
#pragma unroll
            for (int m = 0; m < 4; ++m) { const size_t off = (size_t)(row0 + ai * HALF + m * 16) * 1024 + col0;
#pragma unroll
                for (int bj = 0; bj < 2; ++bj) { const u32x4 b = *(const u32x4*)(SB + off + bj * HALF);
                    const unsigned bw[4] = {b.x, b.y, b.z, b.w}; float v[8];
#pragma unroll
                    for (int q = 0; q < 4; ++q) { v[2 * q] = acc[ai][bj][m][q >> 1][(q & 1) * 2] * fmaxf(bf_lo(bw[q]), 1e-20f); v[2 * q + 1] = acc[ai][bj][m][q >> 1][(q & 1) * 2 + 1] * fmaxf(bf_hi(bw[q]), 1e-20f); }
                    u32x4 w; w.x = cvt_pk_bf16(v[0], v[1]); w.y = cvt_pk_bf16(v[2], v[3]); w.z = cvt_pk_bf16(v[4], v[5]); w.w = cvt_pk_bf16(v[6], v[7]);
                    *(u32x4*)(O + off + bj * HALF) = w; } }
    }
};

template <class Epi, class Sched, bool ALIGN_EPI = false, bool SP2 = false>
__device__ __forceinline__ void gemm_phase(PG8_LAS unsigned char* lds, const Gemm g, const Sched& S, const Epi& E) {
    const int tid = threadIdx.x, wid = __builtin_amdgcn_readfirstlane(tid >> 6), lane = tid & 63, wr = wid >> 2, wc = wid & 3, fr = lane & 15, fq = lane >> 4;
    const int K = g.K;
    unsigned voffA[2], voffB[2];
#pragma unroll
    for (int i = 0; i < 2; ++i) { int R, C; stage_rc(tid * 16 + i * 8192, R, C); const int Rb = Epi::PERM ? ((R & ~31) + perm32(R & 31)) : R;
        voffA[i] = (unsigned)(R * K + C) * 2u; voffB[i] = (unsigned)(Rb * K + C) * 2u; }
    const size_t kstep = (size_t)(BK * 2);
    const size_t hstep = (size_t)HALF * K * 2;
    const size_t tstep = 2 * hstep;
    const unsigned ldsw = (unsigned)wid * 1024u;
    const int aoff = lds_byte(wr * 64 + fr, fq * 8), boff = lds_byte(wc * 32 + fr, fq * 8);
#define PG8_SA(b, h) (((b) * 2 + (h)) * HTB)
#define PG8_SB(b, h) ((4 + (b) * 2 + (h)) * HTB)
#define PG8_STAGE(bufoff, gbase, voff) do { _Pragma("unroll") for (int _i = 0; _i < 2; ++_i) \
        __builtin_amdgcn_global_load_lds((const unsigned*)((const char*)(gbase) + (voff)[_i]), (PG8_LAS unsigned*)(lds + (bufoff) + ldsw + _i * 8192), 16, 0, 0); } while (0)
#define PG8_LDA(dst, b, h) do { _Pragma("unroll") for (int m = 0; m < 4; ++m) _Pragma("unroll") for (int k = 0; k < 2; ++k) dst[m][k] = *(const PG8_LAS bf16x8*)(lds + PG8_SA(b, h) + aoff + m * 2048 + k * 1024); } while (0)
#define PG8_LDB(dst, b, h) do { _Pragma("unroll") for (int n = 0; n < 2; ++n) _Pragma("unroll") for (int k = 0; k < 2; ++k) dst[n][k] = *(const PG8_LAS bf16x8*)(lds + PG8_SB(b, h) + boff + n * 2048 + k * 1024); } while (0)
#define PG8_MMA(ai, bj, At, Bt) do { __builtin_amdgcn_s_setprio(1); _Pragma("unroll") for (int m = 0; m < 4; ++m) _Pragma("unroll") for (int n = 0; n < 2; ++n) _Pragma("unroll") for (int k = 0; k < 2; ++k) \
        acc[ai][bj][m][n] = __builtin_amdgcn_mfma_f32_16x16x32_bf16(Bt[n][k], At[m][k], acc[ai][bj][m][n], 0, 0, 0); __builtin_amdgcn_s_setprio(0); } while (0)
#define PG8_WAIT_V(n) asm volatile("s_waitcnt vmcnt(" #n ")" ::: "memory")
#define PG8_WAIT_L(n) asm volatile("s_waitcnt lgkmcnt(" #n ")" ::: "memory")
#define PG8_BAR __builtin_amdgcn_s_barrier()
#define PG8_SCHED __builtin_amdgcn_sched_barrier(0)
    Unit cur, nxt; int ui = 0;
    if (!S.next(0, cur)) return;
    f32x4 acc[2][2][4][2];
#pragma unroll
    for (int a = 0; a < 2; ++a)
#pragma unroll
        for (int b = 0; b < 2; ++b)
#pragma unroll
            for (int m = 0; m < 4; ++m)
#pragma unroll
                for (int n = 0; n < 2; ++n) acc[a][b][m][n] = (f32x4){0.f, 0.f, 0.f, 0.f};
    bf16x8 At[4][2], B0[2][2], B1[2][2];
    const char* cA = (const char*)g.A + (size_t)cur.pm * tstep + (Sched::SEG ? cur.k0 * 2 : 0); const char* cB = (const char*)g.Bt + (size_t)cur.pn * tstep + (Sched::SEG ? cur.k0 * 2 : 0);
    S.a_ready(cur);
    if constexpr (SP2) {
        PG8_STAGE(PG8_SB(0, 0), cB, voffB); PG8_STAGE(PG8_SB(0, 1), cB + hstep, voffB); PG8_STAGE(PG8_SA(0, 0), cA, voffA); PG8_STAGE(PG8_SA(0, 1), cA + hstep, voffA);
        if (wr == 1) PG8_BAR;
        PG8_WAIT_V(2); PG8_BAR;
        PG8_STAGE(PG8_SB(1, 0), cB + kstep, voffB); PG8_STAGE(PG8_SA(1, 0), cA + kstep, voffA); PG8_STAGE(PG8_SB(1, 1), cB + hstep + kstep, voffB);
        PG8_WAIT_V(6); PG8_BAR;
    } else {
        PG8_STAGE(PG8_SB(0, 0), cB, voffB); PG8_STAGE(PG8_SA(0, 0), cA, voffA); PG8_STAGE(PG8_SB(0, 1), cB + hstep, voffB); PG8_STAGE(PG8_SA(0, 1), cA + hstep, voffA);
        if (wr == 1) PG8_BAR;
        PG8_WAIT_V(4); PG8_BAR;
        PG8_STAGE(PG8_SB(1, 0), cB + kstep, voffB); PG8_STAGE(PG8_SA(1, 0), cA + kstep, voffA); PG8_STAGE(PG8_SB(1, 1), cB + hstep + kstep, voffB);
        PG8_WAIT_V(6); PG8_BAR;
    }
    for (;;) {
        const bool has_next = S.next(ui + 1, nxt);
        const char* nA = has_next ? (const char*)g.A + (size_t)nxt.pm * tstep + (Sched::SEG ? nxt.k0 * 2 : 0) : cA; const char* nB = has_next ? (const char*)g.Bt + (size_t)nxt.pn * tstep + (Sched::SEG ? nxt.k0 * 2 : 0) : cB;
        const int nt = Sched::SEG ? cur.nt : K / BK;
        for (int t = 0; t < nt; t += 2) {
            const bool last = (t == nt - 2);
            const char* a1 = cA + (size_t)(t + 1) * kstep;
            const char* a2 = last ? nA : cA + (size_t)(t + 2) * kstep; const char* b2 = last ? nB : cB + (size_t)(t + 2) * kstep;
            const char* a3 = a2 + kstep; const char* b3 = b2 + kstep;
            if (last && has_next) S.a_ready(nxt);
            if constexpr (SP2) {
            PG8_LDB(B0, 0, 0); PG8_LDB(B1, 0, 1); PG8_SCHED; PG8_LDA(At, 0, 0); PG8_STAGE(PG8_SA(1, 1), a1 + hstep, voffA);
            PG8_WAIT_V(8); PG8_WAIT_L(0); PG8_BAR; PG8_MMA(0, 0, At, B0); PG8_MMA(0, 1, At, B1); PG8_BAR; PG8_SCHED;
            PG8_LDA(At, 0, 1); PG8_STAGE(PG8_SB(0, 0), b2, voffB); PG8_STAGE(PG8_SB(0, 1), b2 + hstep, voffB); PG8_STAGE(PG8_SA(0, 0), a2, voffA);
            PG8_WAIT_V(8); PG8_WAIT_L(0); PG8_BAR; PG8_MMA(1, 0, At, B0); PG8_MMA(1, 1, At, B1); PG8_BAR; PG8_SCHED;
            PG8_LDB(B0, 1, 0); PG8_LDB(B1, 1, 1); PG8_SCHED; PG8_LDA(At, 1, 0); PG8_STAGE(PG8_SA(0, 1), a2 + hstep, voffA);
            PG8_WAIT_V(8); PG8_WAIT_L(0); PG8_BAR; PG8_MMA(0, 0, At, B0); PG8_MMA(0, 1, At, B1); PG8_BAR; PG8_SCHED;
            PG8_LDA(At, 1, 1); PG8_STAGE(PG8_SB(1, 0), b3, voffB); PG8_STAGE(PG8_SB(1, 1), b3 + hstep, voffB); PG8_STAGE(PG8_SA(1, 0), a3, voffA);
            PG8_WAIT_V(8); PG8_WAIT_L(0); PG8_BAR; PG8_MMA(1, 0, At, B0); PG8_MMA(1, 1, At, B1); PG8_BAR; PG8_SCHED;
            } else {
            PG8_LDB(B0, 0, 0); PG8_SCHED; PG8_LDA(At, 0, 0); PG8_STAGE(PG8_SA(1, 1), a1 + hstep, voffA);
            PG8_WAIT_L(8); PG8_BAR; PG8_WAIT_L(0); PG8_MMA(0, 0, At, B0); PG8_BAR; PG8_SCHED;
            PG8_LDB(B1, 0, 1); PG8_STAGE(PG8_SB(0, 0), b2, voffB);
            PG8_BAR; PG8_WAIT_L(0); PG8_MMA(0, 1, At, B1); PG8_BAR;
            PG8_LDA(At, 0, 1); PG8_STAGE(PG8_SA(0, 0), a2, voffA);
            PG8_BAR; PG8_WAIT_L(0); PG8_MMA(1, 0, At, B0); PG8_BAR; PG8_SCHED;
            PG8_STAGE(PG8_SB(0, 1), b2 + hstep, voffB);
            PG8_WAIT_V(6); PG8_BAR; PG8_MMA(1, 1, At, B1); PG8_BAR;
            PG8_LDB(B0, 1, 0); PG8_SCHED; PG8_LDA(At, 1, 0); PG8_STAGE(PG8_SA(0, 1), a2 + hstep, voffA);
            PG8_WAIT_L(8); PG8_BAR; PG8_WAIT_L(0); PG8_MMA(0, 0, At, B0); PG8_BAR; PG8_SCHED;
            PG8_LDB(B1, 1, 1); PG8_STAGE(PG8_SB(1, 0), b3, voffB);
            PG8_BAR; PG8_WAIT_L(0); PG8_MMA(0, 1, At, B1); PG8_BAR;
            PG8_LDA(At, 1, 1); PG8_STAGE(PG8_SA(1, 0), a3, voffA);
            PG8_BAR; PG8_WAIT_L(0); PG8_MMA(1, 0, At, B0); PG8_BAR; PG8_SCHED;
            PG8_STAGE(PG8_SB(1, 1), b3 + hstep, voffB);
            PG8_WAIT_V(6); PG8_BAR; PG8_MMA(1, 1, At, B1); PG8_BAR;
            }
        }
        if constexpr (ALIGN_EPI) { if (wr == 0) PG8_BAR; }
        if constexpr (!Epi::AFTER_DRAIN) { E(acc, cur, wr, wc, fr, fq); S.done(cur); }
        if (!has_next) break;
        if (!(Sched::SEG && cur.seg == 0))
#pragma unroll
        for (int a = 0; a < 2; ++a)
#pragma unroll
            for (int b = 0; b < 2; ++b)
#pragma unroll
                for (int m = 0; m < 4; ++m)
#pragma unroll
                    for (int n = 0; n < 2; ++n) acc[a][b][m][n] = (f32x4){0.f, 0.f, 0.f, 0.f};
        cur = nxt; cA = nA; cB = nB; ++ui;
        if constexpr (ALIGN_EPI) { if (wr == 1) PG8_BAR; }
    }
    PG8_WAIT_V(0);
    if constexpr (!ALIGN_EPI) { if (wr == 0) PG8_BAR; }
    PG8_BAR;
#undef PG8_SA
#undef PG8_SB
#undef PG8_STAGE
#undef PG8_LDA
#undef PG8_LDB
#undef PG8_MMA
#undef PG8_WAIT_V
#undef PG8_WAIT_L
#undef PG8_BAR
#undef PG8_SCHED
}
}

#ifndef PG8_SP2
#define PG8_SP2 true
#endif
#ifndef PG8_ALIGN
#define PG8_ALIGN true
#endif

constexpr int NWAVES = 8;
constexpr int DM = 1024, NBATCH = 8, SEQ = 2048, DBATCH = 128, DSEQ = 4;
constexpr int MP = NBATCH * SEQ, MS = DBATCH * DSEQ, M = MP + MS;
constexpr int NHEAD = 16, NKV = 2, HD = 64, WIN = 128;
constexpr int AW = 512, FF = 2816, NUP = 2 * FF, INW = 4352, KMRG = 1536;
constexpr float LN_EPS = 1e-5f;
constexpr float DN_ALPHA = 1.189207115002721f;
constexpr float LOG2E = 1.4426950408889634f;
constexpr float QSCALE = 0.125f * LOG2E;

constexpr size_t MiB = 1u << 20;
constexpr size_t WS_CTL = 0, CTL_ZERO_BYTES = 256 * 1024;
constexpr size_t WS_ROPE = 512 * 1024;
constexpr size_t WS_WUP1 = 2 * MiB;
constexpr size_t WS_WDN1 = WS_WUP1 + (size_t)NUP * DM * 2;
constexpr size_t WS_WIN = WS_WDN1 + (size_t)DM * FF * 2;
constexpr size_t WS_WMRG = WS_WIN + (size_t)INW * DM * 2;
constexpr size_t WS_WO = WS_WMRG + (size_t)DM * KMRG * 2;
constexpr size_t WS_WUP2 = WS_WO + (size_t)DM * DM * 2;
constexpr size_t WS_WDN2 = WS_WUP2 + (size_t)NUP * DM * 2;
constexpr size_t WS_WEND = WS_WDN2 + (size_t)DM * FF * 2;
static_assert(WS_WEND <= 50 * MiB, "weights");
constexpr size_t WS_ACT = 50 * MiB;
constexpr size_t WS_QA = WS_ACT;
constexpr size_t WS_GV = WS_QA + (size_t)M * KMRG * 2;
constexpr size_t WS_KB = WS_GV + (size_t)M * AW * 2;
constexpr size_t WS_VB = WS_KB + (size_t)M * 128 * 2;
constexpr size_t WS_MRG = WS_GV;
static_assert(WS_VB + (size_t)M * 128 * 2 <= WS_ACT + (size_t)M * FF * 2 && WS_MRG + (size_t)M * DM * 2 <= WS_ACT + (size_t)M * FF * 2, "overlay");
constexpr size_t WS_R1 = 141 * MiB;
constexpr size_t WS_H1 = 175 * MiB;
constexpr size_t WS_SB = 209 * MiB;
constexpr size_t WS_END = 243 * MiB;
static_assert(WS_ACT + (size_t)M * FF * 2 <= WS_R1 && WS_R1 + (size_t)M * DM * 2 <= WS_H1 && WS_H1 + (size_t)M * DM * 2 <= WS_SB && WS_SB + (size_t)M * DM * 2 <= WS_END, "d_ws map");
constexpr int CW_TMO = 0, CW_CODE = 1, CW_BAR = 4096;

constexpr size_t OUT_Y = 0, OUT_WKP = (size_t)M * DM, OUT_WVP = OUT_WKP + 131072, OUT_WKS = OUT_WVP + 131072, OUT_WVS = OUT_WKS + 2097152,
                 OUT_CVP = OUT_WVS + 2097152, OUT_CVS = OUT_CVP + 524288, OUT_END = OUT_CVS + 262144;

constexpr int MISC_OFF = 0, RING_OFF = 512, RING_BYTES = 131072;
constexpr int LDS_BYTES = 147456;

#define GAS __attribute__((address_space(1)))
#define LAS __attribute__((address_space(3)))
typedef unsigned short bf16;
typedef unsigned v4u __attribute__((ext_vector_type(4)));
typedef unsigned v2u __attribute__((ext_vector_type(2)));
typedef float f32x4 __attribute__((ext_vector_type(4)));
typedef float f32x16 __attribute__((ext_vector_type(16)));
typedef short bf16x8 __attribute__((ext_vector_type(8)));
typedef short bf16x4 __attribute__((ext_vector_type(4)));
typedef GAS unsigned gu32;
#define RLX_AGENT __ATOMIC_RELAXED, __HIP_MEMORY_SCOPE_AGENT
#define LDS_WAIT() asm volatile("s_waitcnt lgkmcnt(0)" ::: "memory")
#define VM_WAIT() asm volatile("s_waitcnt vmcnt(0)" ::: "memory")
__device__ __forceinline__ unsigned f2bf(float f) { unsigned u = __builtin_bit_cast(unsigned, f); return (u + 0x7fffu + ((u >> 16) & 1u)) >> 16; }
__device__ __forceinline__ unsigned pk2(float lo, float hi) { return pg8::cvt_pk_bf16(lo, hi); }
using pg8::bf_lo; using pg8::bf_hi;

#define XB_TMO      128
#define XB_XCNT(j)  (256  + 64 * (j))
#define XB_XSUB(j)  (1280 + 64 * (j))
#define XB_XGEN(j)  (2304 + 64 * (j))
#define XB_TOP      3328
#define XB_TOPGEN   3392
#define XCD_BAR_WORDS 3456
#define XB_SPIN_CAP (1u << 18)
__device__ __forceinline__ unsigned xb_ld(unsigned* p)              { return __hip_atomic_load(p, __ATOMIC_RELAXED, __HIP_MEMORY_SCOPE_AGENT); }
__device__ __forceinline__ unsigned xb_add(unsigned* p, unsigned v) { return __hip_atomic_fetch_add(p, v, __ATOMIC_RELAXED, __HIP_MEMORY_SCOPE_AGENT); }
__device__ __forceinline__ unsigned xb_xcc_id() { return (unsigned)__builtin_amdgcn_s_getreg((3 << 11) | 20) & 0xFu; }
#define XB_SPIN(cond, bar) do { unsigned _sp = 0; while (cond) { __builtin_amdgcn_s_sleep(1); \
    if ((++_sp & 255u) == 0u) { if (xb_ld(&(bar)[XB_TMO])) break; if (_sp > XB_SPIN_CAP) { atomicAdd(&(bar)[XB_TMO], 1u); break; } } } } while (0)
struct XcdBarrier { unsigned* bar; unsigned x; volatile LAS unsigned* st; };
__device__ __forceinline__ XcdBarrier xcd_barrier_post(unsigned* bar, volatile LAS unsigned* st) {
    XcdBarrier b; b.bar = bar; b.x = xb_xcc_id(); b.st = st;
    if (threadIdx.x == 0) (void)xb_add(&bar[XB_XCNT(b.x)], 1u);
    return b;
}
__device__ __forceinline__ void xcd_barrier_complete(unsigned* bar, unsigned x, unsigned& nloc, unsigned& nx) {
    const unsigned G = gridDim.x * gridDim.y * gridDim.z;
    unsigned sum, cnt, mine, sp = 0u;
    for (;;) {
        sum = 0u; cnt = 0u; mine = 0u;
#pragma unroll
        for (unsigned j = 0; j < 16; ++j) { const unsigned c = xb_ld(&bar[XB_XCNT(j)]); sum += c; cnt += (c > 0u) ? 1u : 0u; mine = (j == x) ? c : mine; }
        if (sum == G) break;
        __builtin_amdgcn_s_sleep(1);
        if ((++sp & 255u) == 0u) { if (xb_ld(&bar[XB_TMO])) break; if (sp > XB_SPIN_CAP) { atomicAdd(&bar[XB_TMO], 1u); break; } }
    }
    nloc = mine > 0u ? mine : 1u; nx = cnt > 0u ? cnt : 1u;
}
__device__ __forceinline__ void xcd_barrier(const XcdBarrier& b) {
    asm volatile("s_waitcnt vmcnt(0)" ::: "memory");
    __syncthreads();
    if (threadIdx.x == 0) {
        unsigned* bar = b.bar;
        __builtin_amdgcn_s_waitcnt(0);
        unsigned nloc = b.st[0], nx = b.st[1];
        if (nloc == 0u) { xcd_barrier_complete(bar, b.x, nloc, nx); b.st[0] = nloc; b.st[1] = nx; }
        const unsigned old = xb_add(&bar[XB_XSUB(b.x)], 1u);
        const unsigned gen = old / nloc;
        if (old + 1u == (gen + 1u) * nloc) {
            __builtin_amdgcn_fence(__ATOMIC_RELEASE, "agent");
            asm volatile("s_waitcnt vmcnt(0)" ::: "memory");
            const unsigned og = xb_add(&bar[XB_TOP], 1u);
            const unsigned tg = og / nx;
            if (og + 1u == (tg + 1u) * nx) xb_add(&bar[XB_TOPGEN], 1u);
            else XB_SPIN(xb_ld(&bar[XB_TOPGEN]) == tg, bar);
            __builtin_amdgcn_fence(__ATOMIC_ACQUIRE, "agent");
            xb_add(&bar[XB_XGEN(b.x)], 1u);
            asm volatile("s_waitcnt vmcnt(0)" ::: "memory");
        } else {
            XB_SPIN(xb_ld(&bar[XB_XGEN(b.x)]) == gen, bar);
            __builtin_amdgcn_fence(__ATOMIC_ACQUIRE, "agent");
            asm volatile("s_waitcnt vmcnt(0)" ::: "memory");
        }
    }
    __syncthreads();
}

struct Frame {
    LAS unsigned char* lds;
    int tid, lane, wave, vcu, G;
};
__device__ __forceinline__ float wave_sum(float v) {
#pragma unroll
    for (int o = 1; o < 64; o <<= 1) v += __shfl_xor(v, o);
    return v;
}

__device__ __forceinline__ void p0_transpose_item(const float* W, int N, bf16* Bt, int ldb, int koff, int k0, int src0, int dstrow0, LAS float* scr, int lane) {
#pragma unroll 8
    for (int i = 0; i < 32; ++i) { const int kk = 2 * i + (lane >> 5); scr[kk * 33 + (lane & 31)] = W[(size_t)(k0 + kk) * N + src0 + (lane & 31)]; }
    LDS_WAIT(); asm volatile("" ::: "memory");
    const int c = lane & 7;
#pragma unroll
    for (int j = 0; j < 4; ++j) { const int n = (lane >> 3) + 8 * j; const LAS float* s = scr + (8 * c) * 33 + n;
        v4u o; o.x = pk2(s[0 * 33], s[1 * 33]); o.y = pk2(s[2 * 33], s[3 * 33]); o.z = pk2(s[4 * 33], s[5 * 33]); o.w = pk2(s[6 * 33], s[7 * 33]);
        *(GAS v4u*)(Bt + (size_t)(dstrow0 + n) * ldb + koff + k0 + 8 * c) = o; }
    LDS_WAIT(); asm volatile("" ::: "memory");
}
__device__ __forceinline__ int src_up(int rb) { const int pn = rb >> 3, q = rb & 7; return (q < 4) ? pn * 128 + q * 32 : FF + pn * 128 + (q - 4) * 32; }
__device__ __forceinline__ int src_win(int rb) {
    const int pn = rb >> 3, q = rb & 7, bj = q >> 2, wc = q & 3;
    if (pn < 4) return rb * 32;
    if (pn < 8) return 1024 + ((pn - 4) * 4 + wc) * 64 + 32 * bj;
    if (pn == 8) return (wc < 2) ? 2048 + wc * 64 + 32 * bj : 2176 + 64 * bj + 32 * (wc - 2);
    return rb * 32;
}
__constant__ float ROPE_INV[32] = {1.0f, 0.7498942613601685f, 0.5623413324356079f, 0.4216965138912201f, 0.3162277638912201f, 0.23713737726211548f, 0.17782793939113617f, 0.133352130651474f,
    0.10000000149011612f, 0.07498941570520401f, 0.05623413249850273f, 0.04216965287923813f, 0.03162277489900589f, 0.023713737726211548f, 0.017782794311642647f, 0.01333521492779255f,
    0.009999999776482582f, 0.007498941849917173f, 0.005623413249850273f, 0.0042169648222625256f, 0.003162277629598975f, 0.00237137358635664f, 0.0017782794311642647f, 0.0013335214462131262f,
    0.0010000000474974513f, 0.0007498942431993783f, 0.000562341301701963f, 0.0004216965171508491f, 0.0003162277571391314f, 0.00023713737027719617f, 0.00017782794020604342f, 0.0001333521504420787f};
__device__ __forceinline__ void sincos_f32angle(float angf, float& sn, float& cs) {
    const double a = (double)angf;
    const double n = __builtin_rint(a * 0.6366197723675814);
    double y = __builtin_fma(-n, 1.5707963267948966, a); y = __builtin_fma(-n, 6.123233995736766e-17, y);
    const double y2 = y * y;
    double sp = -7.647163731819816e-13; sp = sp * y2 + 1.6059043836821613e-10; sp = sp * y2 - 2.505210838544172e-08; sp = sp * y2 + 2.7557319223985893e-06;
    sp = sp * y2 - 0.0001984126984126984; sp = sp * y2 + 0.008333333333333333; sp = sp * y2 - 0.16666666666666666; const double s = y + y * y2 * sp;
    double cp = 4.779477332387385e-14; cp = cp * y2 - 1.1470745597729725e-11; cp = cp * y2 + 2.08767569878681e-09; cp = cp * y2 - 2.755731922398589e-07;
    cp = cp * y2 + 2.48015873015873e-05; cp = cp * y2 - 0.001388888888888889; cp = cp * y2 + 0.041666666666666664; cp = cp * y2 - 0.5; const double c = 1.0 + y2 * cp;
    const int q = ((int)(long long)n) & 3;
    const double ss = (q == 0) ? s : (q == 1) ? c : (q == 2) ? -s : -c, cc = (q == 0) ? c : (q == 1) ? -s : (q == 2) ? -c : s;
    sn = (float)ss; cs = (float)cc;
}

template <bool OUT_F32> __device__ __forceinline__ void ln_row(const float* zrow, const float* gam, const float* bet, void* orow, int lane) {
    const GAS f32x4* xr = (const GAS f32x4*)zrow + lane;
    f32x4 v[4]; float s = 0.f;
#pragma unroll
    for (int j = 0; j < 4; ++j) { v[j] = xr[64 * j]; s += (v[j].x + v[j].y) + (v[j].z + v[j].w); }
    const float mean = wave_sum(s) * (1.f / DM); float s2 = 0.f;
#pragma unroll
    for (int j = 0; j < 4; ++j) { v[j] = v[j] - mean; s2 += (v[j].x * v[j].x + v[j].y * v[j].y) + (v[j].z * v[j].z + v[j].w * v[j].w); }
    const float rstd = 1.f / sqrtf(wave_sum(s2) * (1.f / DM) + LN_EPS);
#pragma unroll
    for (int j = 0; j < 4; ++j) { const f32x4 g = *((const f32x4*)gam + lane + 64 * j), b = *((const f32x4*)bet + lane + 64 * j);
        const f32x4 o = v[j] * rstd * g + b;
        if (OUT_F32) ((GAS f32x4*)orow)[lane + 64 * j] = o;
        else ((GAS unsigned long long*)orow)[lane + 64 * j] = (unsigned long long)pk2(o.x, o.y) | ((unsigned long long)pk2(o.z, o.w) << 32); }
}

__device__ __forceinline__ int crow(int r, int hi) { return (r & 3) + 8 * (r >> 2) + 4 * hi; }
constexpr int KROW = 144;
template <int VTS> __device__ __forceinline__ void attn_rowblock(const LAS unsigned char* Kimg, const LAS unsigned char* VT, int tile0, const bf16x8 (&qf)[4], float sink2, int lo, int hi,
                                                                 f32x16 (&o)[2], float& linv, int lane) {
    const int r32 = lane & 31, h = lane >> 5;
    f32x16 p[5];
#pragma unroll
    for (int tt = 0; tt < 5; ++tt) { p[tt] = f32x16{};
        const LAS unsigned char* kp = Kimg + ((tile0 + tt) * 32 + r32) * KROW + h * 16;
#pragma unroll
        for (int s = 0; s < 4; ++s) { const bf16x8 kf = *(const LAS bf16x8*)(kp + s * 32); p[tt] = __builtin_amdgcn_mfma_f32_32x32x16_bf16(kf, qf[s], p[tt], 0, 0, 0); } }
    float mx = sink2;
#pragma unroll
    for (int tt = 0; tt < 5; ++tt)
#pragma unroll
        for (int r = 0; r < 16; ++r) { const int j = 32 * (tile0 + tt) + crow(r, h); const bool ok = (j > lo) && (j <= hi); p[tt][r] = ok ? p[tt][r] : -1e30f; mx = fmaxf(mx, p[tt][r]); }
    mx = fmaxf(mx, __shfl_xor(mx, 32));
    float sum = 0.f;
#pragma unroll
    for (int tt = 0; tt < 5; ++tt)
#pragma unroll
        for (int r = 0; r < 16; ++r) { const float e = __builtin_amdgcn_exp2f(p[tt][r] - mx); p[tt][r] = e; sum += e; }
    sum += __shfl_xor(sum, 32); sum += __builtin_amdgcn_exp2f(sink2 - mx);
    linv = 1.0f / sum;
    o[0] = f32x16{}; o[1] = f32x16{};
#pragma unroll
    for (int tt = 0; tt < 5; ++tt)
#pragma unroll
        for (int s16 = 0; s16 < 2; ++s16) {
            v4u pw; pw.x = pk2(p[tt][8 * s16 + 0], p[tt][8 * s16 + 1]); pw.y = pk2(p[tt][8 * s16 + 2], p[tt][8 * s16 + 3]); pw.z = pk2(p[tt][8 * s16 + 4], p[tt][8 * s16 + 5]); pw.w = pk2(p[tt][8 * s16 + 6], p[tt][8 * s16 + 7]);
            const bf16x8 pf = __builtin_bit_cast(bf16x8, pw);
            const int key0 = 32 * (tile0 + tt) + 16 * s16 + 4 * h;
#pragma unroll
            for (int db = 0; db < 2; ++db) { const LAS unsigned char* vp = VT + ((32 * db + r32) * VTS + key0) * 2;
                const v2u a = *(const LAS v2u*)vp, b = *(const LAS v2u*)(vp + 16);
                v4u vw; vw.x = a.x; vw.y = a.y; vw.z = b.x; vw.w = b.y;
                o[db] = __builtin_amdgcn_mfma_f32_32x32x16_bf16(__builtin_bit_cast(bf16x8, vw), pf, o[db], 0, 0, 0); } }
}
__device__ __forceinline__ void attn_store(bf16* rowp, const f32x16 (&o)[2], float linv, int h) {
#pragma unroll
    for (int db = 0; db < 2; ++db)
#pragma unroll
        for (int rg = 0; rg < 4; ++rg) { v2u w; w.x = pk2(o[db][4 * rg] * linv, o[db][4 * rg + 1] * linv); w.y = pk2(o[db][4 * rg + 2] * linv, o[db][4 * rg + 3] * linv);
            *(GAS v2u*)(rowp + 32 * db + 8 * rg + 4 * h) = w; }
}

struct MixArgs { bf16 *QA, *GV, *KB, *VB; const float *ck, *cv, *sinks, *alg, *alb, *aws, *abs_; float *cvp, *cvs; };

__device__ __forceinline__ void attn_prompt_item(const Frame& F, const MixArgs& A, int item) {
    constexpr int VTS = 260;
    const int b = item >> 5, qb = (item >> 1) & 15, kvh = item & 1;
    LAS unsigned char* Kimg = F.lds + RING_OFF; LAS unsigned char* VT = Kimg + 256 * KROW;
    const int row_q0 = b * SEQ + qb * 128, row_k0 = row_q0 - 128;
#pragma unroll
    for (int i = 0; i < 4; ++i) { const int ch = F.tid + i * 512, j = ch >> 3, dc = ch & 7;
        v4u kv = (v4u){0u, 0u, 0u, 0u}, vv = (v4u){0u, 0u, 0u, 0u};
        if (qb > 0 || j >= 128) { kv = *(const GAS v4u*)(A.KB + (size_t)(row_k0 + j) * 128 + kvh * 64 + dc * 8); vv = *(const GAS v4u*)(A.VB + (size_t)(row_k0 + j) * 128 + kvh * 64 + dc * 8); }
        *(LAS v4u*)(Kimg + j * KROW + dc * 16) = kv;
        LAS unsigned short* vt = (LAS unsigned short*)VT + (dc * 8) * VTS + j;
        vt[0 * VTS] = (unsigned short)(vv.x & 0xffff); vt[1 * VTS] = (unsigned short)(vv.x >> 16); vt[2 * VTS] = (unsigned short)(vv.y & 0xffff); vt[3 * VTS] = (unsigned short)(vv.y >> 16);
        vt[4 * VTS] = (unsigned short)(vv.z & 0xffff); vt[5 * VTS] = (unsigned short)(vv.z >> 16); vt[6 * VTS] = (unsigned short)(vv.w & 0xffff); vt[7 * VTS] = (unsigned short)(vv.w >> 16); }
    __syncthreads();
    const int head = kvh * 8 + F.wave, r32 = F.lane & 31, h = F.lane >> 5;
    const float sink2 = A.sinks[head] * LOG2E;
#pragma unroll 1
    for (int r = 0; r < 4; ++r) {
        bf16* qrow = A.QA + (size_t)(row_q0 + 32 * r + r32) * KMRG + 512 + head * 64;
        bf16x8 qf[4];
#pragma unroll
        for (int s = 0; s < 4; ++s) qf[s] = *(const GAS bf16x8*)(qrow + 16 * s + 8 * h);
        const int i = 32 * r + r32; const int lo = (qb == 0 && i < 127) ? 127 : i, hi = i + 128;
        f32x16 o[2]; float linv;
        attn_rowblock<VTS>(Kimg, VT, r, qf, sink2, lo, hi, o, linv, F.lane);
        attn_store(qrow, o, linv, h);
    }
    __syncthreads();
}
__device__ __forceinline__ void sample_item(const Frame& F, const MixArgs& A, int b) {
    constexpr int VTS = 164, KIMG = 160 * KROW, VIMG = 64 * VTS * 2, HSTR = KIMG + VIMG;
    LAS unsigned char* base = F.lds + RING_OFF;
#pragma unroll 1
    for (int ch = F.tid; ch < 2 * 160 * 8; ch += 512) { const int kvh = ch / 1280, rem = ch % 1280, j = rem >> 3, dc = rem & 7;
        v4u kv = (v4u){0u, 0u, 0u, 0u}, vv = (v4u){0u, 0u, 0u, 0u};
        if (j < 128) { const size_t off = (((size_t)b * 128 + j) * 2 + kvh) * 64 + dc * 8;
            const f32x4 k0 = *(const GAS f32x4*)(A.ck + off), k1 = *(const GAS f32x4*)(A.ck + off + 4), v0 = *(const GAS f32x4*)(A.cv + off), v1 = *(const GAS f32x4*)(A.cv + off + 4);
            kv = (v4u){pk2(k0.x, k0.y), pk2(k0.z, k0.w), pk2(k1.x, k1.y), pk2(k1.z, k1.w)}; vv = (v4u){pk2(v0.x, v0.y), pk2(v0.z, v0.w), pk2(v1.x, v1.y), pk2(v1.z, v1.w)};
        } else if (j < 132) { const size_t off = (size_t)(MP + 4 * b + (j - 128)) * 128 + kvh * 64 + dc * 8; kv = *(const GAS v4u*)(A.KB + off); vv = *(const GAS v4u*)(A.VB + off); }
        LAS unsigned char* Kimg = base + kvh * HSTR;
        *(LAS v4u*)(Kimg + j * KROW + dc * 16) = kv;
        LAS unsigned short* vt = (LAS unsigned short*)(Kimg + KIMG) + (dc * 8) * VTS + j;
        vt[0 * VTS] = (unsigned short)(vv.x & 0xffff); vt[1 * VTS] = (unsigned short)(vv.x >> 16); vt[2 * VTS] = (unsigned short)(vv.y & 0xffff); vt[3 * VTS] = (unsigned short)(vv.y >> 16);
        vt[4 * VTS] = (unsigned short)(vv.z & 0xffff); vt[5 * VTS] = (unsigned short)(vv.z >> 16); vt[6 * VTS] = (unsigned short)(vv.w & 0xffff); vt[7 * VTS] = (unsigned short)(vv.w >> 16); }
    __syncthreads();
    if (F.wave < 2) {
        const int kvh = F.wave, r32 = F.lane & 31, h = F.lane >> 5, g = r32 >> 2, t = r32 & 3, head = kvh * 8 + g;
        const LAS unsigned char* Kimg = base + kvh * HSTR;
        bf16* qrow = A.QA + (size_t)(MP + 4 * b + t) * KMRG + 512 + head * 64;
        bf16x8 qf[4];
#pragma unroll
        for (int s = 0; s < 4; ++s) qf[s] = *(const GAS bf16x8*)(qrow + 16 * s + 8 * h);
        f32x16 o[2]; float linv;
        attn_rowblock<VTS>(Kimg, Kimg + KIMG, 0, qf, A.sinks[head] * LOG2E, t, t + 128, o, linv, F.lane);
        attn_store(qrow, o, linv, h);
    } else if (F.wave == 2) {
        const int l = F.lane, g = l >> 4; float vn[4][8]; float gam[8], bet[8];
#pragma unroll
        for (int i = 0; i < 8; ++i) { gam[i] = A.alg[8 * l + i]; bet[i] = A.alb[8 * l + i]; }
#pragma unroll
        for (int t = 0; t < 4; ++t) { const v4u w = *(const GAS v4u*)(A.GV + (size_t)(MP + 4 * b + t) * AW + 8 * l);
            float x[8] = {bf_lo(w.x), bf_hi(w.x), bf_lo(w.y), bf_hi(w.y), bf_lo(w.z), bf_hi(w.z), bf_lo(w.w), bf_hi(w.w)};
            float s = 0.f;
#pragma unroll
            for (int i = 0; i < 8; ++i) s += x[i];
            const float mean = wave_sum(s) * (1.f / AW); float s2 = 0.f;
#pragma unroll
            for (int i = 0; i < 8; ++i) { x[i] -= mean; s2 += x[i] * x[i]; }
            const float rstd = 1.f / sqrtf(wave_sum(s2) * (1.f / AW) + LN_EPS);
#pragma unroll
            for (int i = 0; i < 8; ++i) vn[t][i] = x[i] * rstd * gam[i] + bet[i];
            float* cp = A.cvs + ((size_t)b * 4 + t) * AW + 8 * l;
            *(GAS f32x4*)cp = (f32x4){vn[t][0], vn[t][1], vn[t][2], vn[t][3]}; *(GAS f32x4*)(cp + 4) = (f32x4){vn[t][4], vn[t][5], vn[t][6], vn[t][7]}; }
#pragma unroll
        for (int t = 0; t < 4; ++t) { float mx[8]; const float bias = A.abs_[g * 128 + t];
#pragma unroll
            for (int i = 0; i < 8; ++i) mx[i] = bias;
#pragma unroll
            for (int s = 0; s <= t; ++s) { const float w = A.aws[((size_t)g * 128 + t) * 128 + s];
#pragma unroll
                for (int i = 0; i < 8; ++i) mx[i] += w * vn[s][i]; }
            bf16* up = A.QA + (size_t)(MP + 4 * b + t) * KMRG + 8 * l;
            const v4u uw = *(const GAS v4u*)up;
            v4u ow; ow.x = pk2(bf_lo(uw.x) * mx[0], bf_hi(uw.x) * mx[1]); ow.y = pk2(bf_lo(uw.y) * mx[2], bf_hi(uw.y) * mx[3]); ow.z = pk2(bf_lo(uw.z) * mx[4], bf_hi(uw.z) * mx[5]); ow.w = pk2(bf_lo(uw.w) * mx[6], bf_hi(uw.w) * mx[7]);
            *(GAS v4u*)up = ow; }
    }
    __syncthreads();
}
__device__ __forceinline__ void gmlp_chunk_item(const Frame& F, const MixArgs& A, int item) {
    constexpr int VS = 272;
    const int b = item >> 4, chk = item & 15, row0 = b * SEQ + chk * 128;
    LAS unsigned char* vnT = F.lds + RING_OFF;
    {
        const int l = F.lane; float gam[8], bet[8];
#pragma unroll
        for (int i = 0; i < 8; ++i) { gam[i] = A.alg[8 * l + i]; bet[i] = A.alb[8 * l + i]; }
#pragma unroll 2
        for (int rr = 0; rr < 16; ++rr) { const int s = F.wave * 16 + rr;
            const v4u w = *(const GAS v4u*)(A.GV + (size_t)(row0 + s) * AW + 8 * l);
            float x[8] = {bf_lo(w.x), bf_hi(w.x), bf_lo(w.y), bf_hi(w.y), bf_lo(w.z), bf_hi(w.z), bf_lo(w.w), bf_hi(w.w)};
            float sm = 0.f;
#pragma unroll
            for (int i = 0; i < 8; ++i) sm += x[i];
            const float mean = wave_sum(sm) * (1.f / AW); float s2 = 0.f;
#pragma unroll
            for (int i = 0; i < 8; ++i) { x[i] -= mean; s2 += x[i] * x[i]; }
            const float rstd = 1.f / sqrtf(wave_sum(s2) * (1.f / AW) + LN_EPS);
#pragma unroll
            for (int i = 0; i < 8; ++i) x[i] = x[i] * rstd * gam[i] + bet[i];
            if (chk == 15) { float* cp = A.cvp + ((size_t)b * 128 + s) * AW + 8 * l;
                *(GAS f32x4*)cp = (f32x4){x[0], x[1], x[2], x[3]}; *(GAS f32x4*)(cp + 4) = (f32x4){x[4], x[5], x[6], x[7]}; }
#pragma unroll
            for (int i = 0; i < 8; ++i) *(LAS unsigned short*)(vnT + (8 * l + i) * VS + 2 * s) = (unsigned short)f2bf(x[i]);
        }
    }
    __syncthreads();
    {
        const int g = F.wave >> 1, cb0 = (F.wave & 1) * 2, r32 = F.lane & 31, h = F.lane >> 5;
#pragma unroll 1
        for (int tb = 0; tb < 4; ++tb) {
            f32x16 acc[2]; acc[0] = f32x16{}; acc[1] = f32x16{};
            const int t = 32 * tb + r32;
            const float* wrow = A.aws + ((size_t)g * 128 + t) * 128;
#pragma unroll 1
            for (int ks = 0; ks < 2 * tb + 2; ++ks) { const int s0 = 16 * ks + 8 * h;
                const f32x4 w0 = *(const GAS f32x4*)(wrow + s0), w1 = *(const GAS f32x4*)(wrow + s0 + 4);
                float wv[8] = {w0.x, w0.y, w0.z, w0.w, w1.x, w1.y, w1.z, w1.w};
#pragma unroll
                for (int i = 0; i < 8; ++i) wv[i] = (s0 + i <= t) ? wv[i] : 0.f;
                v4u bw; bw.x = pk2(wv[0], wv[1]); bw.y = pk2(wv[2], wv[3]); bw.z = pk2(wv[4], wv[5]); bw.w = pk2(wv[6], wv[7]);
                const bf16x8 bfr = __builtin_bit_cast(bf16x8, bw);
#pragma unroll
                for (int cb = 0; cb < 2; ++cb) { const bf16x8 af = *(const LAS bf16x8*)(vnT + (g * 128 + 32 * (cb0 + cb) + r32) * VS + s0 * 2);
                    acc[cb] = __builtin_amdgcn_mfma_f32_32x32x16_bf16(af, bfr, acc[cb], 0, 0, 0); } }
            const float bias = A.abs_[g * 128 + t];
            bf16* up = A.QA + (size_t)(row0 + t) * KMRG + g * 128;
#pragma unroll
            for (int cb = 0; cb < 2; ++cb)
#pragma unroll
                for (int rg = 0; rg < 4; ++rg) { bf16* p = up + 32 * (cb0 + cb) + 8 * rg + 4 * h; const v2u uw = *(const GAS v2u*)p;
                    v2u ow; ow.x = pk2(bf_lo(uw.x) * (acc[cb][4 * rg] + bias), bf_hi(uw.x) * (acc[cb][4 * rg + 1] + bias)); ow.y = pk2(bf_lo(uw.y) * (acc[cb][4 * rg + 2] + bias), bf_hi(uw.y) * (acc[cb][4 * rg + 3] + bias));
                    *(GAS v2u*)p = ow; }
        }
    }
    __syncthreads();
}

struct Args { const float* in[23]; float* out; unsigned char* ws; int ph_lo, ph_hi, li, pad; };
constexpr int N_PHASES = 12;

__global__ void __launch_bounds__(NWAVES * 64, 2) fwd_kernel(Args args) {
    extern __shared__ __attribute__((aligned(16))) unsigned char lds_raw[];
    Frame F;
    F.lds = (LAS unsigned char*)lds_raw;
    F.tid = threadIdx.x; F.lane = F.tid & 63; F.wave = __builtin_amdgcn_readfirstlane(F.tid >> 6);
    F.G = gridDim.x; { const int bx = blockIdx.x; F.vcu = (F.G % 8 == 0) ? (bx % 8) * (F.G / 8) + bx / 8 : bx; }
    unsigned char* ws = args.ws;
    gu32* ctl = (gu32*)(ws + WS_CTL);
    volatile LAS unsigned* MISC = (volatile LAS unsigned*)(F.lds + MISC_OFF);
    for (int u = F.tid; u < 128; u += NWAVES * 64) ((LAS unsigned*)(F.lds + MISC_OFF))[u] = 0u;
    __syncthreads();
    const int lo = args.ph_lo, hi = args.ph_hi;
    const bool multi = (hi - lo) > 1;
    XcdBarrier bar; bar.bar = (unsigned*)(ctl + CW_BAR) + args.li * XCD_BAR_WORDS; bar.x = 0; bar.st = nullptr;
    if (multi) bar = xcd_barrier_post((unsigned*)(ctl + CW_BAR) + args.li * XCD_BAR_WORDS, MISC + 8);
#define IN(k) (((PHASE_MASK >> (k)) & 1) && lo <= (k) && (k) < hi)
#define SEAM(k) do { if (IN(k) && IN((k) + 1)) xcd_barrier(bar); } while (0)
    const float* x_p = args.in[0]; const float* x_s = args.in[1];
    float* out = args.out;
    bf16* WUP1 = (bf16*)(ws + WS_WUP1); bf16* WDN1 = (bf16*)(ws + WS_WDN1); bf16* WIN_ = (bf16*)(ws + WS_WIN); bf16* WMRG = (bf16*)(ws + WS_WMRG);
    bf16* WO_ = (bf16*)(ws + WS_WO); bf16* WUP2 = (bf16*)(ws + WS_WUP2); bf16* WDN2 = (bf16*)(ws + WS_WDN2);
    bf16* ACT = (bf16*)(ws + WS_ACT); bf16* QA = (bf16*)(ws + WS_QA); bf16* GV = (bf16*)(ws + WS_GV); bf16* KB = (bf16*)(ws + WS_KB); bf16* VB = (bf16*)(ws + WS_VB);
    bf16* MRG = (bf16*)(ws + WS_MRG); bf16* XB = (bf16*)(ws + WS_R1); bf16* SA = (bf16*)(ws + WS_R1); bf16* H2 = (bf16*)(ws + WS_R1); bf16* H1 = (bf16*)(ws + WS_H1); bf16* SB = (bf16*)(ws + WS_SB);
    float* ROPE = (float*)(ws + WS_ROPE);
    float* Z = out + OUT_Y;
    const int gw = F.vcu * NWAVES + F.wave, NGW = F.G * NWAVES;

    if (IN(0)) {
        LAS float* scr = (LAS float*)(F.lds + RING_OFF + F.wave * 16384);
        constexpr int I_UP = (DM / 64) * (NUP / 32), I_DN = (FF / 64) * (DM / 32), I_IN = (DM / 64) * (INW / 32), I_PA = (AW / 64) * (DM / 32), I_PB = (DM / 64) * (DM / 32), I_O = I_PB;
        constexpr int NITEMS = 2 * I_UP + 2 * I_DN + I_IN + I_PA + I_PB + I_O;
        for (int it = gw; it < NITEMS; it += NGW) {
            int r = it;
            if (r < 2 * I_UP) { const bool second = r >= I_UP; if (second) r -= I_UP; const int nb = NUP / 32, kb = r / nb, rb = r % nb;
                p0_transpose_item(second ? args.in[19] : args.in[4], NUP, second ? WUP2 : WUP1, DM, 0, 64 * kb, src_up(rb), 32 * rb, scr, F.lane); continue; } r -= 2 * I_UP;
            if (r < 2 * I_DN) { const bool second = r >= I_DN; if (second) r -= I_DN; const int nb = DM / 32, kb = r / nb, rb = r % nb;
                p0_transpose_item(second ? args.in[20] : args.in[5], DM, second ? WDN2 : WDN1, FF, 0, 64 * kb, 32 * rb, 32 * rb, scr, F.lane); continue; } r -= 2 * I_DN;
            if (r < I_IN) { const int nb = INW / 32, kb = r / nb, rb = r % nb; p0_transpose_item(args.in[8], INW, WIN_, DM, 0, 64 * kb, src_win(rb), 32 * rb, scr, F.lane); continue; } r -= I_IN;
            if (r < I_PA) { const int nb = DM / 32, kb = r / nb, rb = r % nb; p0_transpose_item(args.in[14], DM, WMRG, KMRG, 0, 64 * kb, 32 * rb, 32 * rb, scr, F.lane); continue; } r -= I_PA;
            if (r < I_PB) { const int nb = DM / 32, kb = r / nb, rb = r % nb; p0_transpose_item(args.in[15], DM, WMRG, KMRG, AW, 64 * kb, 32 * rb, 32 * rb, scr, F.lane); continue; } r -= I_PB;
            { const int nb = DM / 32, kb = r / nb, rb = r % nb; p0_transpose_item(args.in[16], DM, WO_, DM, 0, 64 * kb, 32 * rb, 32 * rb, scr, F.lane); }
        }
        for (int m = gw; m < M; m += NGW) { const float* xr = (m < MP) ? x_p + (size_t)m * DM : x_s + (size_t)(m - MP) * DM;
#pragma unroll
            for (int j = 0; j < 4; ++j) { const f32x4 v = *((const GAS f32x4*)xr + F.lane + 64 * j);
                ((GAS unsigned long long*)(XB + (size_t)m * DM))[F.lane + 64 * j] = (unsigned long long)pk2(v.x, v.y) | ((unsigned long long)pk2(v.z, v.w) << 32); } }
        for (int e = blockIdx.x * 512 + F.tid; e < 2052 * 32; e += F.G * 512) { const int idx = e >> 5, i = e & 31; const int pos = idx < 2048 ? idx : 16384 + (idx - 2048);
            float sn, cs; sincos_f32angle((float)pos * ROPE_INV[i], sn, cs); ROPE[idx * 64 + i] = cs; ROPE[idx * 64 + 32 + i] = sn; }
        for (int e = blockIdx.x * 512 + F.tid; e < 2 * DBATCH * 124 * 32; e += F.G * 512) { const int which = e / (DBATCH * 124 * 32), r = e % (DBATCH * 124 * 32), b = r / (124 * 32), q = r % (124 * 32);
            const float* src = (which ? args.in[3] : args.in[2]) + (size_t)b * 16384 + 512 + q * 4; float* dst = out + (which ? OUT_WVS : OUT_WKS) + (size_t)b * 16384 + q * 4;
            *(GAS f32x4*)dst = *(const GAS f32x4*)src; }
    }
    SEAM(0);
    if (IN(1)) { pg8::Gemm g{XB, WUP1, M, NUP, DM}; pg8::StaticOrder S; S.init(M, NUP, F.G, (int)blockIdx.x); pg8::EpiSwiGLU E{ACT};
        pg8::gemm_phase<pg8::EpiSwiGLU, pg8::StaticOrder, PG8_ALIGN, PG8_SP2>(F.lds + RING_OFF, g, S, E); }
    SEAM(1);
    if (IN(2)) { pg8::Gemm g{ACT, WDN1, M, DM, FF}; pg8::StaticOrder S; S.init(M, DM, F.G, (int)blockIdx.x); pg8::EpiResZ<false> E{x_p, x_s, MP, Z, DN_ALPHA, 0.5f};
        pg8::gemm_phase<pg8::EpiResZ<false>, pg8::StaticOrder, PG8_ALIGN, PG8_SP2>(F.lds + RING_OFF, g, S, E); }
    SEAM(2);
    if (IN(3)) { for (int m = gw; m < M; m += NGW) ln_row<false>(Z + (size_t)m * DM, args.in[6], args.in[7], H1 + (size_t)m * DM, F.lane); }
    SEAM(3);
    if (IN(4)) { pg8::Gemm g{H1, WIN_, M, INW, DM}; pg8::StaticOrder S; S.init(M, INW, F.G, (int)blockIdx.x);
        pg8::EpiWin E{QA, GV, KB, VB, SA, SB, ROPE, out + OUT_WKP, out + OUT_WVP, out + OUT_WKS, out + OUT_WVS, QSCALE};
        pg8::gemm_phase<pg8::EpiWin, pg8::StaticOrder, PG8_ALIGN, PG8_SP2>(F.lds + RING_OFF, g, S, E); }
    SEAM(4);
    if (IN(5)) { MixArgs A{QA, GV, KB, VB, args.in[2], args.in[3], args.in[13], args.in[9], args.in[10], args.in[11], args.in[12], out + OUT_CVP, out + OUT_CVS};
        for (int it = blockIdx.x; it < 256; it += F.G) attn_prompt_item(F, A, it);
        for (int it = blockIdx.x; it < 256; it += F.G) { if (it < 128) gmlp_chunk_item(F, A, it); else sample_item(F, A, it - 128); } }
    SEAM(5);
    if (IN(6)) { pg8::Gemm g{QA, WMRG, M, DM, KMRG}; pg8::TwoSegOrder S; S.init(M, DM, F.G, (int)blockIdx.x); S.nt0 = AW / 64; S.nt1 = DM / 64; pg8::EpiMerged E{SA, SB, MRG};
        pg8::gemm_phase<pg8::EpiMerged, pg8::TwoSegOrder, PG8_ALIGN, PG8_SP2>(F.lds + RING_OFF, g, S, E); }
    SEAM(6);
    if (IN(7)) { pg8::Gemm g{MRG, WO_, M, DM, DM}; pg8::StaticOrder S; S.init(M, DM, F.G, (int)blockIdx.x); pg8::EpiResZ<true> E{H1, H1, 1 << 30, Z, DN_ALPHA, 1.0f};
        pg8::gemm_phase<pg8::EpiResZ<true>, pg8::StaticOrder, PG8_ALIGN, PG8_SP2>(F.lds + RING_OFF, g, S, E); }
    SEAM(7);
    if (IN(8)) { for (int m = gw; m < M; m += NGW) ln_row<false>(Z + (size_t)m * DM, args.in[17], args.in[18], H2 + (size_t)m * DM, F.lane); }
    SEAM(8);
    if (IN(9)) { pg8::Gemm g{H2, WUP2, M, NUP, DM}; pg8::StaticOrder S; S.init(M, NUP, F.G, (int)blockIdx.x); pg8::EpiSwiGLU E{ACT};
        pg8::gemm_phase<pg8::EpiSwiGLU, pg8::StaticOrder, PG8_ALIGN, PG8_SP2>(F.lds + RING_OFF, g, S, E); }
    SEAM(9);
    if (IN(10)) { pg8::Gemm g{ACT, WDN2, M, DM, FF}; pg8::StaticOrder S; S.init(M, DM, F.G, (int)blockIdx.x); pg8::EpiResZ<true> E{H2, H2, 1 << 30, Z, DN_ALPHA, 0.5f};
        pg8::gemm_phase<pg8::EpiResZ<true>, pg8::StaticOrder, PG8_ALIGN, PG8_SP2>(F.lds + RING_OFF, g, S, E); }
    SEAM(10);
    if (IN(11)) { for (int m = gw; m < M; m += NGW) ln_row<true>(Z + (size_t)m * DM, args.in[21], args.in[22], Z + (size_t)m * DM, F.lane); }
#undef IN
#undef SEAM
}

extern "C" void kernel_launch(void* const* d_in, const int* in_sizes, int n_in, void* d_out, int out_size, void* d_ws, size_t ws_size, hipStream_t stream) {
    static int grid = 0;
    if (grid == 0) {
        if (n_in != 23 || (size_t)out_size != OUT_END || ws_size < WS_END) { fprintf(stderr, "kernel_launch: unexpected shapes (n_in %d, out %d, ws %zu)\n", n_in, out_size, ws_size); grid = -1; return; }
        int dev = 0, cus = 0, per_cu = 0;
        if (hipGetDevice(&dev) != hipSuccess || hipDeviceGetAttribute(&cus, hipDeviceAttributeMultiprocessorCount, dev) != hipSuccess) { grid = -1; return; }
        if (hipFuncSetAttribute((const void*)fwd_kernel, hipFuncAttributeMaxDynamicSharedMemorySize, LDS_BYTES) != hipSuccess) { fprintf(stderr, "kernel_launch: hipFuncSetAttribute failed\n"); grid = -1; return; }
        if (hipOccupancyMaxActiveBlocksPerMultiprocessor(&per_cu, (const void*)fwd_kernel, NWAVES * 64, LDS_BYTES) != hipSuccess || per_cu < 1) { fprintf(stderr, "kernel_launch: occupancy query says %d\n", per_cu); per_cu = 1; }
        (void)hipGetLastError();
        grid = cus;
    }
    if (grid < 0) return;
    (void)hipMemsetAsync((char*)d_ws + WS_CTL, 0, CTL_ZERO_BYTES, stream);
    Args a{};
    for (int i = 0; i < 23; ++i) a.in[i] = (const float*)d_in[i];
    a.out = (float*)d_out; a.ws = (unsigned char*)d_ws;
    if (MK_N_LAUNCHES == 1) { a.ph_lo = 0; a.ph_hi = N_PHASES; a.li = 0; hipLaunchKernelGGL(fwd_kernel, dim3(grid), dim3(NWAVES * 64), LDS_BYTES, stream, a); }
    else { for (int p = 0; p < N_PHASES; ++p) { a.ph_lo = p; a.ph_hi = p + 1; a.li = 0; hipLaunchKernelGGL(fwd_kernel, dim3(grid), dim3(NWAVES * 64), LDS_BYTES, stream, a); } }
}
```
